# Optimizing an MI355X kernel written in HIP

```python
import math
import jax
import jax.numpy as jnp
from jax import lax
import numpy as np

D_MODEL = 1024
BATCH = 8
SEQ = 2048
DEPTH = 1

PLE_DIM = 256
POOL_WIDTH = D_MODEL // 2
POOL_GROUPS = 4
POOL_GROUP_DIM = POOL_WIDTH // POOL_GROUPS
POOL_WINDOWS = (2, 4, 8, 16)
SB_HEAD_DIM = 64
SB_HEADS = (D_MODEL // 2) // SB_HEAD_DIM
SB_WIDTH = SB_HEADS * SB_HEAD_DIM
Q_BLOCK = 128
N_BRANCHES = 2
OFF_Q = POOL_WIDTH
OFF_K = OFF_Q + SB_WIDTH
OFF_V = OFF_K + SB_WIDTH
OFF_GATE = OFF_V + SB_WIDTH
IN_WIDTH = OFF_GATE + N_BRANCHES * D_MODEL
N_GROUPS = 4
EXPERTS_PER_GROUP = 8
TOP_K_IN_GROUP = 2
D_EXPERT = D_MODEL // 2
LN_EPS = 1e-5
DEEPNORM_ALPHA = (2.0 * DEPTH) ** 0.25
DEEPNORM_BETA = (8.0 * DEPTH) ** -0.25

kernel_name = "hybrid_pool_stickbreak_hmoe_deepnorm"


def layer_norm(x, g, b):
    xf = x.astype(jnp.float32)
    mu = jnp.mean(xf, axis=-1, keepdims=True)
    var = jnp.mean(jnp.square(xf - mu), axis=-1, keepdims=True)
    y = (xf - mu) * lax.rsqrt(var + LN_EPS)
    return (y * g.astype(jnp.float32) + b.astype(jnp.float32)).astype(x.dtype)


def pool_mixer(u, w_pool, pool_scale):
    bsz, seq, _ = u.shape
    uf = u.astype(jnp.float32)
    csum = jnp.pad(jnp.cumsum(uf, axis=1), ((0, 0), (1, 0), (0, 0)))
    pos = jnp.arange(1, seq + 1, dtype=jnp.float32)
    outs = []
    for g, w in enumerate(POOL_WINDOWS):
        sl = slice(g * POOL_GROUP_DIM, (g + 1) * POOL_GROUP_DIM)
        cg = csum[..., sl]
        lo = jnp.pad(cg, ((0, 0), (w - 1, 0), (0, 0)))[:, :seq]
        cnt = jnp.minimum(pos, float(w))[None, :, None]
        outs.append((cg[:, 1:] - lo) / cnt - uf[..., sl])
    pooled = jnp.stack(outs, axis=2).astype(u.dtype)
    mixed = jnp.einsum('bsgc,gcd->bsgd', pooled, w_pool).reshape(bsz, seq, POOL_WIDTH)
    return mixed * pool_scale


def stick_breaking_attention(q, k, v):
    seq = q.shape[2]
    scale = 1.0 / math.sqrt(q.shape[-1])
    outs = []
    for qb in range(seq // Q_BLOCK):
        start = qb * Q_BLOCK
        end = start + Q_BLOCK
        qf = q[:, :, start:end].astype(jnp.float32)
        kf = k[:, :, :end].astype(jnp.float32)
        z = jnp.einsum('bhqd,bhkd->bhqk', qf, kf) * scale
        qpos = jnp.arange(start, end)
        kpos = jnp.arange(end)
        causal = kpos[None, :] < qpos[:, None]
        log_beta = jax.nn.log_sigmoid(z)
        log_rem = jnp.where(causal, jax.nn.log_sigmoid(-z), 0.0)
        later = lax.cumsum(log_rem, axis=3, reverse=True) - log_rem
        a = jnp.where(causal, jnp.exp(log_beta + later), 0.0)
        outs.append(jnp.einsum('bhqk,bhkd->bhqd', a.astype(v.dtype), v[:, :, :end]))
    return jnp.concatenate(outs, axis=2)


def hierarchical_moe(x, w_rg, b_rg, w_re, b_re, w_eg, w_eu, w_ed):
    bsz, seq, d = x.shape
    xt = x.reshape(-1, d)
    xf = xt.astype(jnp.float32)
    group_probs = jax.nn.softmax(xf @ w_rg.astype(jnp.float32) + b_rg.astype(jnp.float32), axis=-1)
    g_idx = jnp.argmax(group_probs, axis=-1)
    g_prob = jnp.take_along_axis(group_probs, g_idx[:, None], axis=1)[:, 0]
    expert_logits = jnp.einsum('td,gde->tge', xf, w_re.astype(jnp.float32)) + b_re.astype(jnp.float32)
    sel_logits = jnp.take_along_axis(expert_logits, g_idx[:, None, None], axis=1)[:, 0]
    top_vals, top_idx = lax.top_k(sel_logits, TOP_K_IN_GROUP)
    top_w = jax.nn.softmax(top_vals, axis=-1) * g_prob[:, None]
    within = jnp.sum(jax.nn.one_hot(top_idx, EXPERTS_PER_GROUP, dtype=jnp.float32) * top_w[..., None], axis=1)
    combine = (jax.nn.one_hot(g_idx, N_GROUPS, dtype=jnp.float32)[:, :, None] * within[:, None, :]).astype(x.dtype)
    y = jnp.zeros_like(xt)
    for g in range(N_GROUPS):
        for e in range(EXPERTS_PER_GROUP):
            h = jax.nn.silu(xt @ w_eg[g, e]) * (xt @ w_eu[g, e])
            y = y + (h @ w_ed[g, e]) * combine[:, g, e, None]
    return y.reshape(bsz, seq, d)


def setup_inputs(seed: int = 0) -> dict:
    key = jax.random.key(seed)
    ks = jax.random.split(key, 24)
    L, D = DEPTH, D_MODEL

    def nrm(k, shape, scale):
        return jax.random.normal(k, shape, jnp.float32) * scale

    col_scale = jnp.concatenate([
        jnp.ones((POOL_WIDTH + 2 * SB_WIDTH,), jnp.float32),
        jnp.full((SB_WIDTH,), DEEPNORM_BETA, jnp.float32),
        jnp.ones((N_BRANCHES * D,), jnp.float32)])
    return {
        "x": nrm(ks[0], (BATCH, SEQ, D), 1.0),
        "p": nrm(ks[1], (DEPTH, BATCH, SEQ, PLE_DIM), 1.0),
        "w_in": nrm(ks[2], (L, D, IN_WIDTH), D ** -0.5) * col_scale,
        "w_pool": nrm(ks[3], (L, POOL_GROUPS, POOL_GROUP_DIM, POOL_GROUP_DIM), POOL_GROUP_DIM ** -0.5),
        "pool_scale": 1.0 + nrm(ks[4], (L, POOL_WIDTH), 0.1),
        "w_pu": nrm(ks[5], (L, POOL_WIDTH, D), DEEPNORM_BETA * POOL_WIDTH ** -0.5),
        "w_au": nrm(ks[6], (L, SB_WIDTH, D), DEEPNORM_BETA * SB_WIDTH ** -0.5),
        "w_o": nrm(ks[7], (L, D, D), DEEPNORM_BETA * D ** -0.5),
        "ln1_g": 1.0 + nrm(ks[8], (L, D), 0.02),
        "ln1_b": nrm(ks[9], (L, D), 0.02),
        "w_rg": nrm(ks[10], (L, D, N_GROUPS), D ** -0.5),
        "b_rg": nrm(ks[11], (L, N_GROUPS), 0.01),
        "w_re": nrm(ks[12], (L, N_GROUPS, D, EXPERTS_PER_GROUP), D ** -0.5),
        "b_re": nrm(ks[13], (L, N_GROUPS, EXPERTS_PER_GROUP), 0.01),
        "w_eg": nrm(ks[14], (L, N_GROUPS, EXPERTS_PER_GROUP, D, D_EXPERT), DEEPNORM_BETA * D ** -0.5),
        "w_eu": nrm(ks[15], (L, N_GROUPS, EXPERTS_PER_GROUP, D, D_EXPERT), DEEPNORM_BETA * D ** -0.5),
        "w_ed": nrm(ks[16], (L, N_GROUPS, EXPERTS_PER_GROUP, D_EXPERT, D), DEEPNORM_BETA * D_EXPERT ** -0.5),
        "w_pg": nrm(ks[17], (L, D, D), D ** -0.5),
        "w_pp": nrm(ks[18], (L, PLE_DIM, D), DEEPNORM_BETA * PLE_DIM ** -0.5),
        "ln2_g": 1.0 + nrm(ks[19], (L, D), 0.02),
        "ln2_b": nrm(ks[20], (L, D), 0.02),
    }


def reference(x, p, w_in, w_pool, pool_scale, w_pu, w_au, w_o, ln1_g, ln1_b,
              w_rg, b_rg, w_re, b_re, w_eg, w_eu, w_ed, w_pg, w_pp, ln2_g, ln2_b):
    bsz, seq, d = x.shape
    for i in range(DEPTH):
        proj = x @ w_in[i]
        u_pool = proj[..., :OFF_Q]
        q = proj[..., OFF_Q:OFF_K].reshape(bsz, seq, SB_HEADS, SB_HEAD_DIM).transpose(0, 2, 1, 3)
        k = proj[..., OFF_K:OFF_V].reshape(bsz, seq, SB_HEADS, SB_HEAD_DIM).transpose(0, 2, 1, 3)
        v = proj[..., OFF_V:OFF_GATE].reshape(bsz, seq, SB_HEADS, SB_HEAD_DIM).transpose(0, 2, 1, 3)
        gates = jax.nn.sigmoid(proj[..., OFF_GATE:].astype(jnp.float32)).astype(x.dtype)
        gates = gates.reshape(bsz, seq, N_BRANCHES, d)

        pool_out = pool_mixer(u_pool, w_pool[i], pool_scale[i])
        attn_out = stick_breaking_attention(q, k, v).transpose(0, 2, 1, 3).reshape(bsz, seq, SB_WIDTH)

        merged = gates[:, :, 0] * (pool_out @ w_pu[i]) + gates[:, :, 1] * (attn_out @ w_au[i])
        x = layer_norm(DEEPNORM_ALPHA * x + merged @ w_o[i], ln1_g[i], ln1_b[i])

        moe_out = hierarchical_moe(x, w_rg[i], b_rg[i], w_re[i], b_re[i], w_eg[i], w_eu[i], w_ed[i])
        ple = jax.nn.sigmoid(x @ w_pg[i]) * (p[i] @ w_pp[i])
        x = layer_norm(DEEPNORM_ALPHA * x + moe_out + ple, ln2_g[i], ln2_b[i])
    return x
```

```cpp
#include <hip/hip_runtime.h>
#include <cstdint>
#include <cstdio>

namespace nv {
constexpr int T = 16384, S = 2048, NB = 8, D = 1024, INW = 4096, PW = 512, PLE = 256, DE = 512;
constexpr float ALPHA = 1.189207115002721f;
constexpr float LN_EPS = 1e-5f;

struct GemmP {
  const float* A; const float* B; float* C;
  long long sA, sB, sC;
  int lda, ldb, ldc, M, N, K;
  const int* list; const int* off; const int* cnt;
};
__global__ __launch_bounds__(256) void gemm_ref(GemmP p) {
  const int z = blockIdx.z;
  const int M = p.cnt ? p.cnt[z] : p.M;
  const int m0 = blockIdx.y * 64;
  if (m0 >= M) return;
  const int n0 = blockIdx.x * 64;
  const int rb = p.off ? p.off[z] : 0;
  const float* A = p.A + z * p.sA;
  const float* B = p.B + z * p.sB;
  float* C = p.C + z * p.sC;
  __shared__ float As[16][65];
  __shared__ float Bs[16][64];
  const int tid = threadIdx.x, tx = tid & 15, ty = tid >> 4;
  const int ar = tid >> 2, akq = (tid & 3) * 4;
  const int am = m0 + ar;
  long long arow = -1;
  if (am < M) arow = p.list ? (long long)p.list[rb + am] : (long long)(rb + am);
  const float* ap = A + (arow >= 0 ? arow : 0) * p.lda + akq;
  const bool aval = arow >= 0;
  const int bk = tid >> 4, bn = (tid & 15) * 4;
  const float* bp = B + (long long)bk * p.ldb + n0 + bn;
  float acc[4][4];
#pragma unroll
  for (int i = 0; i < 4; ++i)
#pragma unroll
    for (int j = 0; j < 4; ++j) acc[i][j] = 0.f;
  for (int k0 = 0; k0 < p.K; k0 += 16) {
    float4 av = make_float4(0.f, 0.f, 0.f, 0.f);
    if (aval) av = *(const float4*)(ap + k0);
    const float4 bv = *(const float4*)(bp + (long long)k0 * p.ldb);
    As[akq + 0][ar] = av.x; As[akq + 1][ar] = av.y; As[akq + 2][ar] = av.z; As[akq + 3][ar] = av.w;
    Bs[bk][bn + 0] = bv.x; Bs[bk][bn + 1] = bv.y; Bs[bk][bn + 2] = bv.z; Bs[bk][bn + 3] = bv.w;
    __syncthreads();
#pragma unroll
    for (int kk = 0; kk < 16; ++kk) {
      const float a0 = As[kk][ty * 4 + 0], a1 = As[kk][ty * 4 + 1], a2 = As[kk][ty * 4 + 2], a3 = As[kk][ty * 4 + 3];
      const float b0 = Bs[kk][tx * 4 + 0], b1 = Bs[kk][tx * 4 + 1], b2 = Bs[kk][tx * 4 + 2], b3 = Bs[kk][tx * 4 + 3];
      acc[0][0] += a0 * b0; acc[0][1] += a0 * b1; acc[0][2] += a0 * b2; acc[0][3] += a0 * b3;
      acc[1][0] += a1 * b0; acc[1][1] += a1 * b1; acc[1][2] += a1 * b2; acc[1][3] += a1 * b3;
      acc[2][0] += a2 * b0; acc[2][1] += a2 * b1; acc[2][2] += a2 * b2; acc[2][3] += a2 * b3;
      acc[3][0] += a3 * b0; acc[3][1] += a3 * b1; acc[3][2] += a3 * b2; acc[3][3] += a3 * b3;
    }
    __syncthreads();
  }
#pragma unroll
  for (int i = 0; i < 4; ++i) {
    const int m = m0 + ty * 4 + i;
    if (m < M) {
      float* cp = C + (long long)(rb + m) * p.ldc + n0 + tx * 4;
      *(float4*)cp = make_float4(acc[i][0], acc[i][1], acc[i][2], acc[i][3]);
    }
  }
}

__device__ __forceinline__ float sigmoidf_(float x) { return 1.f / (1.f + expf(-x)); }

__global__ void k_sigmoid_gates(float* proj) {
  const int i = blockIdx.x * blockDim.x + threadIdx.x;
  const int t = i >> 11, c = i & 2047;
  float* p = proj + (long long)t * INW + 2048 + c;
  *p = sigmoidf_(*p);
}
__global__ void k_pooled(const float* proj, float* pooled) {
  const int i = blockIdx.x * blockDim.x + threadIdx.x;
  const int t = i >> 9, c = i & 511;
  const int g = c >> 7, w = 2 << g;
  const int lo = (t - w + 1) > 0 ? (t - w + 1) : 0;
  float s = 0.f;
  for (int r = lo; r <= t; ++r) s += proj[(long long)r * INW + c];
  const float cnt = (float)(t - lo + 1);
  pooled[i] = s / cnt - proj[(long long)t * INW + c];
}
__global__ void k_scale_cols(float* mixed, const float* scale) {
  const int i = blockIdx.x * blockDim.x + threadIdx.x;
  mixed[i] *= scale[i & 511];
}
__global__ __launch_bounds__(64) void k_attn(const float* proj, float* att) {
  const int qb = blockIdx.x, h = blockIdx.y, lane = threadIdx.x;
  const int t = qb * 64 + lane;
  __shared__ float Ks[64][64];
  __shared__ float Vs[64][64];
  float q[64], acc[64];
  const float* qp = proj + (long long)t * INW + 512 + h * 64;
#pragma unroll
  for (int d = 0; d < 64; ++d) { q[d] = qp[d] * 0.125f; acc[d] = 0.f; }
  float carry = 0.f;
  for (int kb = qb * 64; kb >= 0; kb -= 64) {
    __syncthreads();
    const float* kp = proj + (long long)(kb + lane) * INW + 1024 + h * 64;
    const float* vp = proj + (long long)(kb + lane) * INW + 1536 + h * 64;
#pragma unroll
    for (int d = 0; d < 64; ++d) { Ks[lane][d] = kp[d]; Vs[lane][d] = vp[d]; }
    __syncthreads();
    for (int s = 63; s >= 0; --s) {
      const int key = kb + s;
      float z = 0.f;
#pragma unroll
      for (int d = 0; d < 64; ++d) z += q[d] * Ks[s][d];
      const float lb = fminf(z, 0.f) - log1pf(expf(-fabsf(z)));
      const float lr = lb - z;
      if (key < t) {
        const float a = expf(lb + carry);
#pragma unroll
        for (int d = 0; d < 64; ++d) acc[d] += a * Vs[s][d];
        carry += lr;
      }
    }
  }
  float* op = att + (long long)t * PW + h * 64;
#pragma unroll
  for (int d = 0; d < 64; ++d) op[d] = acc[d];
}
__global__ void k_merge(float* a1, const float* a2, const float* proj) {
  const int i = blockIdx.x * blockDim.x + threadIdx.x;
  const int t = i >> 10, c = i & 1023;
  const float gp = proj[(long long)t * INW + 2048 + c], ga = proj[(long long)t * INW + 3072 + c];
  a1[i] = gp * a1[i] + ga * a2[i];
}
__device__ __forceinline__ float wave_sum(float v) {
#pragma unroll
  for (int o = 32; o > 0; o >>= 1) v += __shfl_xor(v, o);
  return v;
}
__global__ void k_ln1(const float* x, const float* add, const float* g, const float* b, float* out) {
  const int row = blockIdx.x * 4 + (threadIdx.x >> 6), lane = threadIdx.x & 63;
  float v[16]; float s = 0.f;
#pragma unroll
  for (int j = 0; j < 16; ++j) { const int c = lane + 64 * j; v[j] = ALPHA * x[(long long)row * D + c] + add[(long long)row * D + c]; s += v[j]; }
  const float mean = wave_sum(s) * (1.f / D);
  float q = 0.f;
#pragma unroll
  for (int j = 0; j < 16; ++j) { v[j] -= mean; q += v[j] * v[j]; }
  const float rstd = 1.f / sqrtf(wave_sum(q) * (1.f / D) + LN_EPS);
#pragma unroll
  for (int j = 0; j < 16; ++j) { const int c = lane + 64 * j; out[(long long)row * D + c] = v[j] * rstd * g[c] + b[c]; }
}
__global__ void k_router(const float* x1, const float* w_rg, const float* b_rg, const float* w_re, const float* b_re,
                         int* e0, int* e1, float* w0, float* w1) {
  const int t = blockIdx.x * 4 + (threadIdx.x >> 6), lane = threadIdx.x & 63;
  const float* xr = x1 + (long long)t * D;
  float gl[4] = {0.f, 0.f, 0.f, 0.f};
  for (int j = 0; j < 16; ++j) { const int d = lane + 64 * j; const float xv = xr[d];
#pragma unroll
    for (int g = 0; g < 4; ++g) gl[g] += xv * w_rg[d * 4 + g]; }
#pragma unroll
  for (int g = 0; g < 4; ++g) gl[g] = wave_sum(gl[g]) + b_rg[g];
  int gi = 0; float gm = gl[0];
#pragma unroll
  for (int g = 1; g < 4; ++g) if (gl[g] > gm) { gm = gl[g]; gi = g; }
  float den = 0.f;
#pragma unroll
  for (int g = 0; g < 4; ++g) den += expf(gl[g] - gm);
  const float gprob = 1.f / den;
  float el[8] = {0.f, 0.f, 0.f, 0.f, 0.f, 0.f, 0.f, 0.f};
  const float* wr = w_re + (long long)gi * D * 8;
  for (int j = 0; j < 16; ++j) { const int d = lane + 64 * j; const float xv = xr[d];
#pragma unroll
    for (int e = 0; e < 8; ++e) el[e] += xv * wr[d * 8 + e]; }
#pragma unroll
  for (int e = 0; e < 8; ++e) el[e] = wave_sum(el[e]) + b_re[gi * 8 + e];
  int i0 = 0; float v0 = el[0];
#pragma unroll
  for (int e = 1; e < 8; ++e) if (el[e] > v0) { v0 = el[e]; i0 = e; }
  int i1 = -1; float v1 = -INFINITY;
#pragma unroll
  for (int e = 0; e < 8; ++e) if (e != i0 && el[e] > v1) { v1 = el[e]; i1 = e; }
  const float ex = expf(v1 - v0);
  const float s0 = 1.f / (1.f + ex), s1 = ex / (1.f + ex);
  if (lane == 0) { e0[t] = gi * 8 + i0; e1[t] = gi * 8 + i1; w0[t] = s0 * gprob; w1[t] = s1 * gprob; }
}
__global__ __launch_bounds__(64) void k_count(const int* e0, const int* e1, int* cnt) {
  const int z = blockIdx.x, lane = threadIdx.x; int c = 0;
  for (int t0 = 0; t0 < S; t0 += 64) { const int t = t0 + lane; const bool m = (e0[t] == z) || (e1[t] == z); c += __popcll(__ballot(m)); }
  if (lane == 0) cnt[z] = c;
}
__global__ void k_offsets(const int* cnt, int* off) { if (threadIdx.x == 0 && blockIdx.x == 0) { int a = 0; for (int z = 0; z < 32; ++z) { off[z] = a; a += cnt[z]; } } }
__global__ __launch_bounds__(64) void k_fill(const int* e0, const int* e1, const int* off, int* list, int* pos0, int* pos1) {
  const int z = blockIdx.x, lane = threadIdx.x; int run = off[z];
  for (int t0 = 0; t0 < S; t0 += 64) { const int t = t0 + lane; const bool m0 = (e0[t] == z), m1 = (e1[t] == z); const bool m = m0 || m1;
    const unsigned long long bal = __ballot(m); const int idx = run + __popcll(bal & ((1ull << lane) - 1ull));
    if (m) { list[idx] = t; if (m0) pos0[t] = idx; else pos1[t] = idx; }
    run += __popcll(bal); }
}
__global__ void k_swiglu(float* gc, const float* uc) {
  const int i = blockIdx.x * blockDim.x + threadIdx.x;
  const float g = gc[i]; gc[i] = g * sigmoidf_(g) * uc[i];
}
__global__ void k_final(const float* x1, const float* yc, const int* pos0, const int* pos1, const float* w0, const float* w1,
                        const float* G, const float* U, const float* g, const float* b, float* out) {
  const int row = blockIdx.x * 4 + (threadIdx.x >> 6), lane = threadIdx.x & 63;
  const float* y0 = yc + (long long)pos0[row] * D; const float* y1 = yc + (long long)pos1[row] * D; const float a0 = w0[row], a1 = w1[row];
  float v[16]; float s = 0.f;
#pragma unroll
  for (int j = 0; j < 16; ++j) { const int c = lane + 64 * j; const long long i = (long long)row * D + c;
    v[j] = ALPHA * x1[i] + (y0[c] * a0 + y1[c] * a1) + sigmoidf_(G[i]) * U[i]; s += v[j]; }
  const float mean = wave_sum(s) * (1.f / D);
  float q = 0.f;
#pragma unroll
  for (int j = 0; j < 16; ++j) { v[j] -= mean; q += v[j] * v[j]; }
  const float rstd = 1.f / sqrtf(wave_sum(q) * (1.f / D) + LN_EPS);
#pragma unroll
  for (int j = 0; j < 16; ++j) { const int c = lane + 64 * j; out[(long long)row * D + c] = v[j] * rstd * g[c] + b[c]; }
}

inline void gemm(hipStream_t st, const float* A, int lda, const float* B, int ldb, float* C, int ldc, int M, int N, int K,
                 int nz = 1, long long sA = 0, long long sB = 0, long long sC = 0, const int* list = nullptr, const int* off = nullptr, const int* cnt = nullptr) {
  GemmP p{}; p.A = A; p.B = B; p.C = C; p.sA = sA; p.sB = sB; p.sC = sC; p.lda = lda; p.ldb = ldb; p.ldc = ldc; p.M = M; p.N = N; p.K = K; p.list = list; p.off = off; p.cnt = cnt;
  hipLaunchKernelGGL(gemm_ref, dim3(N / 64, (M + 63) / 64, nz), dim3(256), 0, st, p);
}

constexpr size_t MiB = 1u << 20;
constexpr size_t O_PROJ = 0, O_POOLED = 32 * MiB, O_MIXED = 36 * MiB, O_ATT = 40 * MiB, O_A1 = 44 * MiB, O_A2 = 52 * MiB, O_TO = 60 * MiB, O_X1 = 68 * MiB,
                 O_G = 76 * MiB, O_U = 84 * MiB, O_GC = 92 * MiB, O_UC = 100 * MiB, O_YC = 108 * MiB, O_RT = 124 * MiB, NAIVE_END = 125 * MiB;

inline void forward(void* const* d_in, float* out, unsigned char* ws, hipStream_t st) {
  const float* x = (const float*)d_in[0]; const float* pin = (const float*)d_in[1]; const float* w_in = (const float*)d_in[2]; const float* w_pool = (const float*)d_in[3];
  const float* pool_scale = (const float*)d_in[4]; const float* w_pu = (const float*)d_in[5]; const float* w_au = (const float*)d_in[6]; const float* w_o = (const float*)d_in[7];
  const float* ln1_g = (const float*)d_in[8]; const float* ln1_b = (const float*)d_in[9]; const float* w_rg = (const float*)d_in[10]; const float* b_rg = (const float*)d_in[11];
  const float* w_re = (const float*)d_in[12]; const float* b_re = (const float*)d_in[13]; const float* w_eg = (const float*)d_in[14]; const float* w_eu = (const float*)d_in[15];
  const float* w_ed = (const float*)d_in[16]; const float* w_pg = (const float*)d_in[17]; const float* w_pp = (const float*)d_in[18]; const float* ln2_g = (const float*)d_in[19]; const float* ln2_b = (const float*)d_in[20];
  float* PROJ = (float*)(ws + O_PROJ); float* POOLED = (float*)(ws + O_POOLED); float* MIXED = (float*)(ws + O_MIXED); float* ATT = (float*)(ws + O_ATT);
  float* A1 = (float*)(ws + O_A1); float* A2 = (float*)(ws + O_A2); float* TO = (float*)(ws + O_TO); float* X1 = (float*)(ws + O_X1); float* G = (float*)(ws + O_G); float* U = (float*)(ws + O_U);
  float* GC = (float*)(ws + O_GC); float* UC = (float*)(ws + O_UC); float* YC = (float*)(ws + O_YC);
  int* e0 = (int*)(ws + O_RT); int* e1 = e0 + S; float* w0 = (float*)(e1 + S); float* w1 = w0 + S; int* pos0 = (int*)(w1 + S); int* pos1 = pos0 + S; int* cnt = pos1 + S; int* off = cnt + 32; int* list = off + 32;
  for (int b = 0; b < NB; ++b) {
    const float* xb = x + (size_t)b * S * D; const float* pb = pin + (size_t)b * S * PLE; float* ob = out + (size_t)b * S * D;
    gemm(st, xb, D, w_in, INW, PROJ, INW, S, INW, D);
    hipLaunchKernelGGL(k_sigmoid_gates, dim3(S * 2048 / 256), dim3(256), 0, st, PROJ);
    hipLaunchKernelGGL(k_pooled, dim3(S * PW / 256), dim3(256), 0, st, (const float*)PROJ, POOLED);
    gemm(st, POOLED, PW, w_pool, 128, MIXED, PW, S, 128, 128, 4, 128, 128 * 128, 128);
    hipLaunchKernelGGL(k_scale_cols, dim3(S * PW / 256), dim3(256), 0, st, MIXED, pool_scale);
    hipLaunchKernelGGL(k_attn, dim3(S / 64, 8), dim3(64), 0, st, (const float*)PROJ, ATT);
    gemm(st, MIXED, PW, w_pu, D, A1, D, S, D, PW);
    gemm(st, ATT, PW, w_au, D, A2, D, S, D, PW);
    hipLaunchKernelGGL(k_merge, dim3(S * D / 256), dim3(256), 0, st, A1, (const float*)A2, (const float*)PROJ);
    gemm(st, A1, D, w_o, D, TO, D, S, D, D);
    hipLaunchKernelGGL(k_ln1, dim3(S / 4), dim3(256), 0, st, xb, (const float*)TO, ln1_g, ln1_b, X1);
    gemm(st, X1, D, w_pg, D, G, D, S, D, D);
    gemm(st, pb, PLE, w_pp, D, U, D, S, D, PLE);
    hipLaunchKernelGGL(k_router, dim3(S / 4), dim3(256), 0, st, (const float*)X1, w_rg, b_rg, w_re, b_re, e0, e1, w0, w1);
    hipLaunchKernelGGL(k_count, dim3(32), dim3(64), 0, st, (const int*)e0, (const int*)e1, cnt);
    hipLaunchKernelGGL(k_offsets, dim3(1), dim3(64), 0, st, (const int*)cnt, off);
    hipLaunchKernelGGL(k_fill, dim3(32), dim3(64), 0, st, (const int*)e0, (const int*)e1, (const int*)off, list, pos0, pos1);
    gemm(st, X1, D, w_eg, DE, GC, DE, S, DE, D, 32, 0, (long long)D * DE, 0, list, off, cnt);
    gemm(st, X1, D, w_eu, DE, UC, DE, S, DE, D, 32, 0, (long long)D * DE, 0, list, off, cnt);
    hipLaunchKernelGGL(k_swiglu, dim3(4096 * DE / 256), dim3(256), 0, st, GC, (const float*)UC);
    gemm(st, GC, DE, w_ed, D, YC, D, S, D, DE, 32, 0, (long long)DE * D, 0, nullptr, off, cnt);
    hipLaunchKernelGGL(k_final, dim3(S / 4), dim3(256), 0, st, (const float*)X1, (const float*)YC, (const int*)pos0, (const int*)pos1, (const float*)w0, (const float*)w1,
                       (const float*)G, (const float*)U, ln2_g, ln2_b, ob);
  }
}
}

extern "C" void kernel_launch(void* const* d_in, const int* in_sizes, int n_in, void* d_out, int out_size, void* d_ws, size_t ws_size, hipStream_t stream) {
  nv::forward(d_in, (float*)d_out, (unsigned char*)d_ws, stream);
}
```
